# Optimizing an MI355X kernel written in HIP

```python
import jax, jax.numpy as jnp
from jax import lax
import numpy as np

D_MODEL = 2048
BATCH = 4
SEQ = 2048
DEPTH = 2

GRID_W = 64
CTX_LEN = 256
N_HEADS = 16
N_KV_HEADS = 4
GROUP = N_HEADS // N_KV_HEADS
HEAD_DIM = 128
WINDOW = 128
BLOCK = 128
ROPE_THETA = 10000.0
CONV_WIDTH = 3
D_CONV = D_MODEL
D_FF = 5632
N_EXPERTS = 8
TOP_K = 2
D_FF_EXPERT = 7168
RMS_EPS = 1e-6
NEG_INF = -1e30
N_MOD = 6
N_DENSE = (DEPTH + 1) // 2
N_MOE = DEPTH // 2
Q_W = N_HEADS * HEAD_DIM
KV_W = N_KV_HEADS * HEAD_DIM
SPLIT_POINTS = (Q_W, Q_W + KV_W, Q_W + 2 * KV_W, Q_W + 2 * KV_W + D_CONV, Q_W + 2 * KV_W + 2 * D_CONV, Q_W + 2 * KV_W + 3 * D_CONV, Q_W + 2 * KV_W + 3 * D_CONV + D_MODEL)
P_WIDTH = Q_W + 2 * KV_W + 3 * D_CONV + 2 * D_MODEL

kernel_name = "hybrid_gated_swa_shortconv_moe_dit"


def rmsnorm(t, g):
    tf = t.astype(jnp.float32)
    tf = tf * lax.rsqrt(jnp.mean(tf * tf, axis=-1, keepdims=True) + RMS_EPS)
    return tf.astype(t.dtype) * g


def rope_1d(t, pos):
    half = t.shape[-1] // 2
    inv_freq = jnp.power(ROPE_THETA, -jnp.arange(half, dtype=jnp.float32) / half)
    ang = pos.astype(jnp.float32)[:, None] * inv_freq[None, :]
    cos = jnp.cos(ang)[:, None, :]
    sin = jnp.sin(ang)[:, None, :]
    t1 = t[..., :half].astype(jnp.float32)
    t2 = t[..., half:].astype(jnp.float32)
    return jnp.concatenate([t1 * cos - t2 * sin, t2 * cos + t1 * sin], axis=-1).astype(t.dtype)


def rope_2d(t, rows, cols):
    half = t.shape[-1] // 2
    return jnp.concatenate([rope_1d(t[..., :half], rows), rope_1d(t[..., half:], cols)], axis=-1)


def latent_attention(q, k, v, kc, vc, sink):
    b, s = q.shape[0], q.shape[1]
    nb = s // BLOCK
    scale = HEAD_DIM ** -0.5
    pad = ((0, 0), (BLOCK, BLOCK), (0, 0), (0, 0))
    kp = jnp.pad(k, pad).reshape(b, nb + 2, BLOCK, N_KV_HEADS, HEAD_DIM)
    vp = jnp.pad(v, pad).reshape(b, nb + 2, BLOCK, N_KV_HEADS, HEAD_DIM)
    kband = jnp.concatenate([kp[:, :-2], kp[:, 1:-1], kp[:, 2:]], axis=2)
    vband = jnp.concatenate([vp[:, :-2], vp[:, 1:-1], vp[:, 2:]], axis=2)
    qb = q.reshape(b, nb, BLOCK, N_KV_HEADS, GROUP, HEAD_DIM)
    s_loc = jnp.einsum('bnqhgd,bnkhd->bhgnqk', qb, kband).astype(jnp.float32) * scale
    blk = jnp.arange(nb)[:, None, None] * BLOCK
    qpos = blk + jnp.arange(BLOCK)[None, :, None]
    kpos = blk - BLOCK + jnp.arange(3 * BLOCK)[None, None, :]
    valid = (jnp.abs(qpos - kpos) <= WINDOW) & (kpos >= 0) & (kpos < s)
    s_loc = jnp.where(valid, s_loc, NEG_INF)
    s_ctx = jnp.einsum('bnqhgd,bchd->bhgnqc', qb, kc).astype(jnp.float32) * scale
    sink_col = jnp.broadcast_to(sink.astype(jnp.float32).reshape(N_KV_HEADS, GROUP)[None, :, :, None, None, None], s_loc.shape[:-1] + (1,))
    probs = jax.nn.softmax(jnp.concatenate([s_loc, s_ctx, sink_col], axis=-1), axis=-1).astype(v.dtype)
    n_ctx = kc.shape[1]
    p_loc = probs[..., :3 * BLOCK]
    p_ctx = probs[..., 3 * BLOCK:3 * BLOCK + n_ctx]
    o = jnp.einsum('bhgnqk,bnkhd->bnqhgd', p_loc, vband) + jnp.einsum('bhgnqc,bchd->bnqhgd', p_ctx, vc)
    return o.reshape(b, s, N_HEADS * HEAD_DIM)


def context_attention(qc, kc, vc, sink):
    b, n = qc.shape[0], qc.shape[1]
    scale = HEAD_DIM ** -0.5
    qg = qc.reshape(b, n, N_KV_HEADS, GROUP, HEAD_DIM)
    sc = jnp.einsum('bqhgd,bkhd->bhgqk', qg, kc).astype(jnp.float32) * scale
    sink_col = jnp.broadcast_to(sink.astype(jnp.float32).reshape(N_KV_HEADS, GROUP)[None, :, :, None, None], sc.shape[:-1] + (1,))
    probs = jax.nn.softmax(jnp.concatenate([sc, sink_col], axis=-1), axis=-1).astype(vc.dtype)
    o = jnp.einsum('bhgqk,bkhd->bqhgd', probs[..., :n], vc)
    return o.reshape(b, n, N_HEADS * HEAD_DIM)


def short_conv(u, gate_b, gate_c, w):
    z = gate_c * u
    n = z.shape[1]
    zp = jnp.pad(z, ((0, 0), (CONV_WIDTH // 2, CONV_WIDTH // 2), (0, 0)))
    y = zp[:, 0:n] * w[0]
    for i in range(1, CONV_WIDTH):
        y = y + zp[:, i:i + n] * w[i]
    return gate_b * y


def merge_branches(y_attn, y_conv, g_attn, g_conv, w_oa, w_oc, w_o):
    return (jax.nn.sigmoid(g_attn) * (y_attn @ w_oa) + jax.nn.sigmoid(g_conv) * (y_conv @ w_oc)) @ w_o


def swiglu(t, w1, w3, w2):
    return (jax.nn.silu(t @ w1) * (t @ w3)) @ w2


def moe_swiglu(t, w_router, w1, w3, w2):
    shp = t.shape
    tf = t.reshape(-1, shp[-1])
    logits = (tf @ w_router).astype(jnp.float32)
    top_vals, top_idx = lax.top_k(logits, TOP_K)
    top_p = jax.nn.softmax(top_vals, axis=-1)
    combine = jnp.sum(jax.nn.one_hot(top_idx, N_EXPERTS, dtype=jnp.float32) * top_p[..., None], axis=1).astype(t.dtype)
    out = jnp.zeros_like(tf)
    for e in range(N_EXPERTS):
        out = out + combine[:, e:e + 1] * swiglu(tf, w1[e], w3[e], w2[e])
    return out.reshape(shp)


def setup_inputs(seed: int = 0) -> dict:
    key = jax.random.key(seed)
    ks = jax.random.split(key, 24)
    f32 = jnp.float32

    def dense(k, shape, fan_in, gain=1.0):
        return jax.random.normal(k, shape, f32) * (gain * fan_in ** -0.5)

    return {
        "x": jax.random.normal(ks[0], (BATCH, SEQ, D_MODEL), f32),
        "c": jax.random.normal(ks[1], (BATCH, D_MODEL), f32),
        "ctx": jax.random.normal(ks[2], (BATCH, CTX_LEN, D_MODEL), f32),
        "c_ctx": jax.random.normal(ks[3], (D_MODEL,), f32),
        "w_mod": dense(ks[4], (DEPTH, D_MODEL, N_MOD * D_MODEL), D_MODEL, 0.5),
        "b_mod": 0.02 * jax.random.normal(ks[5], (DEPTH, N_MOD * D_MODEL), f32),
        "norm1": 1.0 + 0.02 * jax.random.normal(ks[6], (DEPTH, D_MODEL), f32),
        "w_in": dense(ks[7], (DEPTH, D_MODEL, P_WIDTH), D_MODEL),
        "sink": 0.5 * jax.random.normal(ks[8], (DEPTH, N_HEADS), f32),
        "conv_w": dense(ks[9], (DEPTH, CONV_WIDTH, D_CONV), CONV_WIDTH),
        "w_o_attn": dense(ks[10], (DEPTH, Q_W, D_MODEL), Q_W),
        "w_o_conv": dense(ks[11], (DEPTH, D_CONV, D_MODEL), D_CONV),
        "w_out": dense(ks[12], (DEPTH, D_MODEL, D_MODEL), D_MODEL),
        "norm2": 1.0 + 0.02 * jax.random.normal(ks[13], (DEPTH, D_MODEL), f32),
        "ffn_w1": dense(ks[14], (N_DENSE, D_MODEL, D_FF), D_MODEL),
        "ffn_w3": dense(ks[15], (N_DENSE, D_MODEL, D_FF), D_MODEL),
        "ffn_w2": dense(ks[16], (N_DENSE, D_FF, D_MODEL), D_FF),
        "router": dense(ks[17], (N_MOE, D_MODEL, N_EXPERTS), D_MODEL),
        "moe_w1": dense(ks[18], (N_MOE, N_EXPERTS, D_MODEL, D_FF_EXPERT), D_MODEL),
        "moe_w3": dense(ks[19], (N_MOE, N_EXPERTS, D_MODEL, D_FF_EXPERT), D_MODEL),
        "moe_w2": dense(ks[20], (N_MOE, N_EXPERTS, D_FF_EXPERT, D_MODEL), D_FF_EXPERT),
        "norm_f": 1.0 + 0.02 * jax.random.normal(ks[21], (D_MODEL,), f32),
    }


def reference(x, c, ctx, c_ctx, w_mod, b_mod, norm1, w_in, sink, conv_w, w_o_attn, w_o_conv, w_out, norm2, ffn_w1, ffn_w3, ffn_w2, router, moe_w1, moe_w3, moe_w2, norm_f):
    b, s, _ = x.shape
    n_ctx = ctx.shape[1]
    n_rows = s // GRID_W
    rows = jnp.broadcast_to(jnp.arange(n_rows)[:, None], (n_rows, GRID_W)).reshape(s)
    cols = jnp.broadcast_to(jnp.arange(GRID_W)[None, :], (n_rows, GRID_W)).reshape(s)
    c_act = jax.nn.silu(c)
    cc_act = jax.nn.silu(c_ctx)
    xc = ctx
    for layer in range(DEPTH):
        ctx_out = layer < DEPTH - 1
        mod = c_act @ w_mod[layer] + b_mod[layer]
        mod_c = cc_act @ w_mod[layer] + b_mod[layer]
        sh1, sc1, g1, sh2, sc2, g2 = jnp.split(mod, N_MOD, axis=-1)
        csh1, csc1, cg1, csh2, csc2, cg2 = jnp.split(mod_c, N_MOD, axis=-1)

        h = rmsnorm(x, norm1[layer]) * (1.0 + sc1[:, None]) + sh1[:, None]
        hc = rmsnorm(xc, norm1[layer]) * (1.0 + csc1) + csh1
        q, k, v, u, gate_b, gate_c, ga, gc = jnp.split(h @ w_in[layer], list(SPLIT_POINTS), axis=-1)
        q = rope_2d(q.reshape(b, s, N_HEADS, HEAD_DIM), rows, cols)
        k = rope_2d(k.reshape(b, s, N_KV_HEADS, HEAD_DIM), rows, cols)
        v = v.reshape(b, s, N_KV_HEADS, HEAD_DIM)
        if ctx_out:
            qc, kc, vc, uc, gate_bc, gate_cc, gac, gcc = jnp.split(hc @ w_in[layer], list(SPLIT_POINTS), axis=-1)
        else:
            kc, vc = jnp.split(hc @ w_in[layer][:, Q_W:Q_W + 2 * KV_W], 2, axis=-1)
        kc = kc.reshape(b, n_ctx, N_KV_HEADS, HEAD_DIM)
        vc = vc.reshape(b, n_ctx, N_KV_HEADS, HEAD_DIM)

        y_attn = latent_attention(q, k, v, kc, vc, sink[layer])
        y_conv = short_conv(u, gate_b, gate_c, conv_w[layer])
        x = x + g1[:, None] * merge_branches(y_attn, y_conv, ga, gc, w_o_attn[layer], w_o_conv[layer], w_out[layer])
        if ctx_out:
            yc_attn = context_attention(qc.reshape(b, n_ctx, N_HEADS, HEAD_DIM), kc, vc, sink[layer])
            yc_conv = short_conv(uc, gate_bc, gate_cc, conv_w[layer])
            xc = xc + cg1 * merge_branches(yc_attn, yc_conv, gac, gcc, w_o_attn[layer], w_o_conv[layer], w_out[layer])

        h = rmsnorm(x, norm2[layer]) * (1.0 + sc2[:, None]) + sh2[:, None]
        if layer % 2 == 0:
            i = layer // 2
            x = x + g2[:, None] * swiglu(h, ffn_w1[i], ffn_w3[i], ffn_w2[i])
            if ctx_out:
                hc = rmsnorm(xc, norm2[layer]) * (1.0 + csc2) + csh2
                xc = xc + cg2 * swiglu(hc, ffn_w1[i], ffn_w3[i], ffn_w2[i])
        else:
            i = layer // 2
            x = x + g2[:, None] * moe_swiglu(h, router[i], moe_w1[i], moe_w3[i], moe_w2[i])
            if ctx_out:
                hc = rmsnorm(xc, norm2[layer]) * (1.0 + csc2) + csh2
                xc = xc + cg2 * moe_swiglu(hc, router[i], moe_w1[i], moe_w3[i], moe_w2[i])
    return rmsnorm(x, norm_f)
```

```cpp
#include <hip/hip_runtime.h>
#include <cstdio>
#include <cstdint>

#ifndef MK_SPLIT
#define MK_SPLIT 0
#endif

#define LAS __attribute__((address_space(3)))
#define GAS __attribute__((address_space(1)))
typedef unsigned short bf16_t;
typedef short bf16x8 __attribute__((ext_vector_type(8)));
typedef short s16x4 __attribute__((ext_vector_type(4)));
typedef float f32x4 __attribute__((ext_vector_type(4)));
typedef float f32x2 __attribute__((ext_vector_type(2)));
typedef float f32x16 __attribute__((ext_vector_type(16)));
typedef unsigned u32x4 __attribute__((ext_vector_type(4)));
typedef unsigned u32x2 __attribute__((ext_vector_type(2)));

constexpr int DM = 2048, NB = 4, SEQ = 2048, CTX = 256, NH = 16, NKV = 4, HD = 128;
constexpr int MLAT = NB * SEQ;
constexpr int MCTX = NB * CTX;
constexpr int MALL = MLAT + MCTX;
constexpr int PW = 13312;
constexpr int COL_K = 2048, COL_V = 2560, COL_U = 3072, COL_GB = 5120, COL_GC = 7168, COL_GA = 9216, COL_GCV = 11264;
constexpr int DFF = 5632, DFE = 7168, NE = 8;
constexpr int NMOD = 6 * DM;
constexpr int KS_MOD = 16;
constexpr int MOE_ROWS = 2 * MLAT + NE * 256;
constexpr float RMS_EPS = 1e-6f;

constexpr size_t AL(size_t x) { return (x + 255) & ~(size_t)255; }
constexpr size_t WS_CTL = 0, CTL_BYTES = 1u << 20;
constexpr size_t WS_MODP = WS_CTL + CTL_BYTES;
constexpr size_t WS_MODT = WS_MODP + AL((size_t)KS_MOD * 2 * 5 * NMOD * 4);
constexpr size_t WS_ROPE = WS_MODT + AL((size_t)2 * 5 * NMOD * 4);
constexpr size_t WS_MOEI = WS_ROPE + AL(64 * 32 * 2 * 4);
constexpr size_t MOEI_BYTES = 1u << 20;
constexpr size_t WS_WIN = WS_MOEI + MOEI_BYTES;
constexpr size_t WS_WMG = WS_WIN + AL((size_t)2 * PW * DM * 2);
constexpr size_t WS_WOUT = WS_WMG + AL((size_t)2 * DM * 2 * DM * 2);
constexpr size_t WS_WF13 = WS_WOUT + AL((size_t)2 * DM * DM * 2);
constexpr size_t WS_WF2 = WS_WF13 + AL((size_t)2 * DFF * DM * 2);
constexpr size_t WS_WM13 = WS_WF2 + AL((size_t)DM * DFF * 2);
constexpr size_t WS_WM2 = WS_WM13 + AL((size_t)NE * 2 * DFE * DM * 2);
constexpr size_t WS_X = WS_WM2 + AL((size_t)NE * DM * DFE * 2);
constexpr size_t WS_H = WS_X + AL((size_t)MALL * DM * 4);
constexpr size_t WS_R1 = WS_H + AL((size_t)MALL * DM * 2);
constexpr size_t R1_BYTES = AL((size_t)MOE_ROWS * DFE * 2);
constexpr size_t WS_Y = WS_R1 + R1_BYTES;
constexpr size_t WS_MB = WS_Y + AL((size_t)MALL * 2 * DM * 2);
constexpr size_t WS_AS = WS_MB + AL((size_t)MALL * DM * 2);
constexpr size_t WS_OS = WS_AS + AL((size_t)MOE_ROWS * DM * 2);
constexpr size_t WS_END = WS_OS + AL((size_t)MOE_ROWS * DM * 2);
static_assert((size_t)MALL * PW * 2 <= R1_BYTES, "P fits R1");
constexpr int MI_TOKE = 0;
constexpr int MI_TOKP = 16384;
constexpr int MI_SLOT = 32768;
constexpr int MI_CNTWG = 49152;
constexpr int MI_PANE = 51200;
constexpr int MI_NPAN = 51200 + 96;
constexpr int CW_BAR = 4096;

constexpr int RING_BYTES = 131072;
constexpr int LDS_BYTES = 147456;
constexpr int MISC_OFF = 147456 - 256;

__device__ __forceinline__ unsigned cvt_pk_bf16(float lo, float hi) { unsigned r; asm volatile("v_cvt_pk_bf16_f32 %0, %1, %2" : "=v"(r) : "v"(lo), "v"(hi)); return r; }
__device__ __forceinline__ u32x4 pack8(f32x4 a, f32x4 b) { u32x4 w; w.x = cvt_pk_bf16(a[0], a[1]); w.y = cvt_pk_bf16(a[2], a[3]); w.z = cvt_pk_bf16(b[0], b[1]); w.w = cvt_pk_bf16(b[2], b[3]); return w; }
__device__ __forceinline__ float bf_lo(unsigned w) { return __uint_as_float(w << 16); }
__device__ __forceinline__ float bf_hi(unsigned w) { return __uint_as_float(w & 0xffff0000u); }
__device__ __forceinline__ float wave_sum(float v) {
#pragma unroll
    for (int o = 1; o < 64; o <<= 1) v += __shfl_xor(v, o);
    return v;
}
__device__ __forceinline__ float fast_sigmoid(float x) { return __builtin_amdgcn_rcpf(1.0f + __builtin_amdgcn_exp2f(-1.4426950408889634f * x)); }
#define LDS_WAIT() asm volatile("s_waitcnt lgkmcnt(0)" ::: "memory")
#define VM_WAIT() asm volatile("s_waitcnt vmcnt(0)" ::: "memory")

#define XB_TMO      128
#define XB_XCNT(j)  (256  + 64 * (j))
#define XB_XSUB(j)  (1280 + 64 * (j))
#define XB_XGEN(j)  (2304 + 64 * (j))
#define XB_TOP      3328
#define XB_TOPGEN   3392
#define XCD_BAR_WORDS 3456
#define XB_SPIN_CAP (1u << 18)
__device__ __forceinline__ unsigned xb_ld(unsigned* p)              { return __hip_atomic_load(p, __ATOMIC_RELAXED, __HIP_MEMORY_SCOPE_AGENT); }
__device__ __forceinline__ unsigned xb_add(unsigned* p, unsigned v) { return __hip_atomic_fetch_add(p, v, __ATOMIC_RELAXED, __HIP_MEMORY_SCOPE_AGENT); }
__device__ __forceinline__ unsigned xb_xcc_id() { return (unsigned)__builtin_amdgcn_s_getreg((3 << 11) | 20) & 0xFu; }
#define XB_SPIN(cond, bar) do { unsigned _sp = 0; while (cond) { __builtin_amdgcn_s_sleep(1); \
    if ((++_sp & 255u) == 0u) { if (xb_ld(&(bar)[XB_TMO])) break; if (_sp > XB_SPIN_CAP) { atomicAdd(&(bar)[XB_TMO], 1u); break; } } } } while (0)
struct XcdBarrier { unsigned* bar; unsigned x; volatile LAS unsigned* st; };
__device__ __forceinline__ XcdBarrier xcd_barrier_post(unsigned* bar, volatile LAS unsigned* st) {
    XcdBarrier b; b.bar = bar; b.x = xb_xcc_id(); b.st = st;
    if (threadIdx.x == 0) (void)xb_add(&bar[XB_XCNT(b.x)], 1u);
    return b;
}
__device__ __forceinline__ void xcd_barrier_complete(unsigned* bar, unsigned x, unsigned& nloc, unsigned& nx) {
    const unsigned G = gridDim.x * gridDim.y * gridDim.z;
    unsigned sum, cnt, mine, sp = 0u;
    for (;;) {
        sum = 0u; cnt = 0u; mine = 0u;
#pragma unroll
        for (unsigned j = 0; j < 16; ++j) { const unsigned c = xb_ld(&bar[XB_XCNT(j)]); sum += c; cnt += (c > 0u) ? 1u : 0u; mine = (j == x) ? c : mine; }
        if (sum == G) break;
        __builtin_amdgcn_s_sleep(1);
        if ((++sp & 255u) == 0u) { if (xb_ld(&bar[XB_TMO])) break; if (sp > XB_SPIN_CAP) { atomicAdd(&bar[XB_TMO], 1u); break; } }
    }
    nloc = mine > 0u ? mine : 1u; nx = cnt > 0u ? cnt : 1u;
}
__device__ __forceinline__ void xcd_barrier(const XcdBarrier& b) {
    asm volatile("s_waitcnt vmcnt(0)" ::: "memory");
    __syncthreads();
    if (threadIdx.x == 0) {
        unsigned* bar = b.bar;
        __builtin_amdgcn_s_waitcnt(0);
        unsigned nloc = b.st[0], nx = b.st[1];
        if (nloc == 0u) { xcd_barrier_complete(bar, b.x, nloc, nx); b.st[0] = nloc; b.st[1] = nx; }
        const unsigned old = xb_add(&bar[XB_XSUB(b.x)], 1u);
        const unsigned gen = old / nloc;
        if (old + 1u == (gen + 1u) * nloc) {
            __builtin_amdgcn_fence(__ATOMIC_RELEASE, "agent");
            asm volatile("s_waitcnt vmcnt(0)" ::: "memory");
            const unsigned og = xb_add(&bar[XB_TOP], 1u);
            const unsigned tg = og / nx;
            if (og + 1u == (tg + 1u) * nx) xb_add(&bar[XB_TOPGEN], 1u);
            else XB_SPIN(xb_ld(&bar[XB_TOPGEN]) == tg, bar);
            __builtin_amdgcn_fence(__ATOMIC_ACQUIRE, "agent");
            xb_add(&bar[XB_XGEN(b.x)], 1u);
            asm volatile("s_waitcnt vmcnt(0)" ::: "memory");
        } else {
            XB_SPIN(xb_ld(&bar[XB_XGEN(b.x)]) == gen, bar);
            __builtin_amdgcn_fence(__ATOMIC_ACQUIRE, "agent");
            asm volatile("s_waitcnt vmcnt(0)" ::: "memory");
        }
    }
    __syncthreads();
}

namespace pg8 {
constexpr int BM = 256, BK = 64, HALF = 128, HTB = HALF * BK * 2, STAGE_BYTES = 8 * HTB, NXCD = 8, WGM = 8;
__host__ __device__ __forceinline__ int lds_byte(int r, int c) { const int st = (r >> 4) * 2 + (c >> 5), rr = r & 15, cc = c & 31, ob = rr * 64 + cc * 2; return st * 1024 + (ob ^ (((ob >> 9) & 1) << 5)); }
__host__ __device__ __forceinline__ void stage_rc(int b, int& R, int& C) { const int st = b / 1024, sb = b % 1024, swz = sb ^ (((sb >> 9) & 1) << 5); R = (st >> 1) * 16 + swz / 64; C = (st & 1) * 32 + (swz % 64) / 2; }
__host__ __device__ __forceinline__ int perm32(int rho) { const int n = rho >> 4, i = rho & 15; return 8 * (i >> 2) + 4 * n + (i & 3); }

struct Unit { int pm, pn, half; const char* A; const char* B; };

struct Order {
    int nM, nN, nwg, G, c; int nXN, nx, xm0, xn0;
    const char* A; const char* Bt; size_t atile, btile; const int* pane; size_t estride; int split2; size_t khalf;
    __device__ void init(const void* A_, const void* Bt_, int ld, int nM_, int nN_, int G_, int c_) {
        A = (const char*)A_; Bt = (const char*)Bt_; atile = (size_t)BM * ld * 2; btile = atile; nM = nM_; nN = nN_; nwg = nM * nN; G = G_; c = c_; nXN = 1; nx = 0; xm0 = 0; xn0 = 0; pane = nullptr; estride = 0; split2 = 0; khalf = 0; }
    __device__ bool next(int i, Unit& u) const {
        u.half = split2 ? (i & 1) : 0; if (split2) i >>= 1;
        const long L = (long)i * G + c; if (L >= nwg + nx) return false;
        if (L < nwg) {
            int wgid = (int)L; { const int q = nwg / NXCD, r = nwg % NXCD, xcd = wgid % NXCD, off = wgid / NXCD; wgid = (xcd < r ? xcd * (q + 1) : r * (q + 1) + (xcd - r) * q) + off; }
            const int nig = WGM * nN, gid = wgid / nig, fm = gid * WGM, gsz = (nM - fm) < WGM ? (nM - fm) : WGM;
            u.pm = fm + ((wgid % nig) % gsz); u.pn = (wgid % nig) / gsz;
        } else { const int e = (int)(L - nwg); u.pm = xm0 + e / nXN; u.pn = xn0 + e % nXN; }
        u.A = A + (size_t)u.pm * atile + (u.half ? khalf : (size_t)0);
        u.B = Bt + (size_t)u.pn * btile + (pane ? (size_t)pane[u.pm] * estride : (size_t)0) + (u.half ? khalf : (size_t)0);
        return true;
    }
};

template <class Epi>
__device__ __forceinline__ void gemm_phase(LAS unsigned char* lds, const int K, const int ld, const Order& S, const Epi& E) {
    int tid_ = threadIdx.x; asm volatile("" : "+v"(tid_));
    const int tid = tid_, wid = __builtin_amdgcn_readfirstlane(tid >> 6), lane = tid & 63, wr = wid >> 2, wc = wid & 3, fr = lane & 15, fq = lane >> 4;
    const int nt = K / BK;
    unsigned voffA[2], voffB[2];
#pragma unroll
    for (int i = 0; i < 2; ++i) { int R, C; stage_rc(tid * 16 + i * 8192, R, C); const int Rb = (R & ~31) + perm32(R & 31);
        voffA[i] = (unsigned)(R * ld + C) * 2u; voffB[i] = (unsigned)(Rb * ld + C) * 2u; }
    const size_t kstep = (size_t)(BK * 2);
    const size_t hstep = (size_t)HALF * ld * 2;
    const unsigned ldsw = (unsigned)wid * 1024u;
    const int aoff = lds_byte(wr * 64 + fr, fq * 8), boff = lds_byte(wc * 32 + fr, fq * 8);
#define PG8_SA(b, h) (((b) * 2 + (h)) * HTB)
#define PG8_SB(b, h) ((4 + (b) * 2 + (h)) * HTB)
#define PG8_STAGE(bufoff, gbase, voff) do { _Pragma("unroll") for (int _i = 0; _i < 2; ++_i) \
        __builtin_amdgcn_global_load_lds((const unsigned*)((const char*)(gbase) + (voff)[_i]), (LAS unsigned*)(lds + (bufoff) + ldsw + _i * 8192), 16, 0, 0); } while (0)
#define PG8_LDA(dst, b, h) do { _Pragma("unroll") for (int m = 0; m < 4; ++m) _Pragma("unroll") for (int k = 0; k < 2; ++k) dst[m][k] = *(const LAS bf16x8*)(lds + PG8_SA(b, h) + aoff + m * 2048 + k * 1024); } while (0)
#define PG8_LDB(dst, b, h) do { _Pragma("unroll") for (int n = 0; n < 2; ++n) _Pragma("unroll") for (int k = 0; k < 2; ++k) dst[n][k] = *(const LAS bf16x8*)(lds + PG8_SB(b, h) + boff + n * 2048 + k * 1024); } while (0)
#define PG8_MMA(ai, bj, At, Bt) do { __builtin_amdgcn_s_setprio(1); _Pragma("unroll") for (int m = 0; m < 4; ++m) _Pragma("unroll") for (int n = 0; n < 2; ++n) _Pragma("unroll") for (int k = 0; k < 2; ++k) \
        acc[ai][bj][m][n] = __builtin_amdgcn_mfma_f32_16x16x32_bf16(Bt[n][k], At[m][k], acc[ai][bj][m][n], 0, 0, 0); __builtin_amdgcn_s_setprio(0); } while (0)
#define PG8_WAIT_V(n) asm volatile("s_waitcnt vmcnt(" #n ")" ::: "memory")
#define PG8_WAIT_L(n) asm volatile("s_waitcnt lgkmcnt(" #n ")" ::: "memory")
#define PG8_BAR __builtin_amdgcn_s_barrier()
#define PG8_SCHED __builtin_amdgcn_sched_barrier(0)
    Unit cur, nxt; int ui = 0;
    if (!S.next(0, cur)) return;
    f32x4 acc[2][2][4][2];
#pragma unroll
    for (int a = 0; a < 2; ++a)
#pragma unroll
        for (int b = 0; b < 2; ++b)
#pragma unroll
            for (int m = 0; m < 4; ++m)
#pragma unroll
                for (int n = 0; n < 2; ++n) acc[a][b][m][n] = (f32x4){0.f, 0.f, 0.f, 0.f};
    bf16x8 At[4][2], B0[2][2], B1[2][2];
    const char* cA = cur.A; const char* cB = cur.B;
    PG8_STAGE(PG8_SB(0, 0), cB, voffB); PG8_STAGE(PG8_SB(0, 1), cB + hstep, voffB); PG8_STAGE(PG8_SA(0, 0), cA, voffA); PG8_STAGE(PG8_SA(0, 1), cA + hstep, voffA);
    if (wr == 1) PG8_BAR;
    PG8_WAIT_V(2); PG8_BAR;
    PG8_STAGE(PG8_SB(1, 0), cB + kstep, voffB); PG8_STAGE(PG8_SA(1, 0), cA + kstep, voffA); PG8_STAGE(PG8_SB(1, 1), cB + hstep + kstep, voffB);
    PG8_WAIT_V(6); PG8_BAR;
    for (;;) {
        const bool has_next = S.next(ui + 1, nxt);
        const char* nA = has_next ? nxt.A : cA; const char* nB = has_next ? nxt.B : cB;
        for (int t = 0; t < nt; t += 2) {
            const bool last = (t == nt - 2);
            const char* a1 = cA + (size_t)(t + 1) * kstep;
            const char* a2 = last ? nA : cA + (size_t)(t + 2) * kstep; const char* b2 = last ? nB : cB + (size_t)(t + 2) * kstep;
            const char* a3 = a2 + kstep; const char* b3 = b2 + kstep;
            PG8_LDB(B0, 0, 0); PG8_LDB(B1, 0, 1); PG8_SCHED; PG8_LDA(At, 0, 0); PG8_STAGE(PG8_SA(1, 1), a1 + hstep, voffA);
            PG8_WAIT_V(8); PG8_WAIT_L(0); PG8_BAR; PG8_MMA(0, 0, At, B0); PG8_MMA(0, 1, At, B1); PG8_BAR; PG8_SCHED;
            PG8_LDA(At, 0, 1); PG8_STAGE(PG8_SB(0, 0), b2, voffB); PG8_STAGE(PG8_SB(0, 1), b2 + hstep, voffB); PG8_STAGE(PG8_SA(0, 0), a2, voffA);
            PG8_WAIT_V(8); PG8_WAIT_L(0); PG8_BAR; PG8_MMA(1, 0, At, B0); PG8_MMA(1, 1, At, B1); PG8_BAR; PG8_SCHED;
            PG8_LDB(B0, 1, 0); PG8_LDB(B1, 1, 1); PG8_SCHED; PG8_LDA(At, 1, 0); PG8_STAGE(PG8_SA(0, 1), a2 + hstep, voffA);
            PG8_WAIT_V(8); PG8_WAIT_L(0); PG8_BAR; PG8_MMA(0, 0, At, B0); PG8_MMA(0, 1, At, B1); PG8_BAR; PG8_SCHED;
            PG8_LDA(At, 1, 1); PG8_STAGE(PG8_SB(1, 0), b3, voffB); PG8_STAGE(PG8_SB(1, 1), b3 + hstep, voffB); PG8_STAGE(PG8_SA(1, 0), a3, voffA);
            PG8_WAIT_V(8); PG8_WAIT_L(0); PG8_BAR; PG8_MMA(1, 0, At, B0); PG8_MMA(1, 1, At, B1); PG8_BAR; PG8_SCHED;
        }
        if (wr == 0) PG8_BAR;
        E(acc, cur, wr, wc, fr, fq);
        if (!has_next) break;
#pragma unroll
        for (int a = 0; a < 2; ++a)
#pragma unroll
            for (int b = 0; b < 2; ++b)
#pragma unroll
                for (int m = 0; m < 4; ++m)
#pragma unroll
                    for (int n = 0; n < 2; ++n) acc[a][b][m][n] = (f32x4){0.f, 0.f, 0.f, 0.f};
        cur = nxt; cA = nA; cB = nB; ++ui;
        if (wr == 1) PG8_BAR;
    }
    PG8_WAIT_V(0);
    PG8_BAR;
#undef PG8_SA
#undef PG8_SB
#undef PG8_STAGE
#undef PG8_LDA
#undef PG8_LDB
#undef PG8_MMA
#undef PG8_WAIT_V
#undef PG8_WAIT_L
#undef PG8_BAR
#undef PG8_SCHED
}
}

using pg8::Unit;
__device__ __forceinline__ int row_b5(int pm) { return pm < 32 ? (pm >> 3) : 4; }

struct EpiWin {
    bf16_t* P; const float* rope;
    __device__ __forceinline__ void operator()(const f32x4 (&acc)[2][2][4][2], const Unit& u, int wr, int wc, int fr, int fq) const {
        const int row0 = u.pm * 256 + wr * 64 + fr;
        if (u.pn < 10) {
            const int colb = u.pn * 256 + wc * 64 + 8 * fq;
            const bool lat = u.pm < 32;
#pragma unroll
            for (int ai = 0; ai < 2; ++ai)
#pragma unroll
                for (int m = 0; m < 4; ++m) {
                    const int r = row0 + ai * 128 + m * 16;
                    bf16_t* rowp = P + (size_t)r * PW + colb;
                    f32x4 x1a = acc[ai][0][m][0], x1b = acc[ai][0][m][1], x2a = acc[ai][1][m][0], x2b = acc[ai][1][m][1];
                    if (lat) {
                        const int s = r & (SEQ - 1); const int pidx = (wc & 1) ? (s & 63) : (s >> 6);
                        const float* ct = rope + pidx * 32 + 8 * fq; const float* st = ct + 64 * 32;
                        const f32x4 c0 = *(const f32x4*)ct, c1 = *(const f32x4*)(ct + 4), s0 = *(const f32x4*)st, s1 = *(const f32x4*)(st + 4);
                        const f32x4 o1a = x1a * c0 - x2a * s0, o1b = x1b * c1 - x2b * s1, o2a = x2a * c0 + x1a * s0, o2b = x2b * c1 + x1b * s1;
                        x1a = o1a; x1b = o1b; x2a = o2a; x2b = o2b;
                    }
                    *(u32x4*)rowp = pack8(x1a, x1b); *(u32x4*)(rowp + 32) = pack8(x2a, x2b);
                }
        } else {
            const int colb = u.pn * 256 + wc * 32 + 8 * fq;
#pragma unroll
            for (int ai = 0; ai < 2; ++ai)
#pragma unroll
                for (int m = 0; m < 4; ++m) {
                    bf16_t* rowp = P + (size_t)(row0 + ai * 128 + m * 16) * PW + colb;
#pragma unroll
                    for (int bj = 0; bj < 2; ++bj) *(u32x4*)(rowp + bj * 128) = pack8(acc[ai][bj][m][0], acc[ai][bj][m][1]);
                }
        }
    }
};

struct EpiMerge {
    const bf16_t* P; float* T; bf16_t* O;
    __device__ __forceinline__ void operator()(const f32x4 (&acc)[2][2][4][2], const Unit& u, int wr, int wc, int fr, int fq) const {
        const int row0 = u.pm * 256 + wr * 64 + fr, colb = u.pn * 256 + wc * 32 + 8 * fq;
        const int gcol = (u.half ? COL_GCV : COL_GA) + colb;
#pragma unroll
        for (int ai = 0; ai < 2; ++ai)
#pragma unroll
            for (int m = 0; m < 4; ++m) {
                const size_t r = (size_t)(row0 + ai * 128 + m * 16);
#pragma unroll
                for (int bj = 0; bj < 2; ++bj) {
                    const u32x4 g = *(const u32x4*)(P + r * PW + gcol + bj * 128);
                    const unsigned gw[4] = {g.x, g.y, g.z, g.w};
                    f32x4 v0 = acc[ai][bj][m][0], v1 = acc[ai][bj][m][1];
                    v0[0] *= fast_sigmoid(bf_lo(gw[0])); v0[1] *= fast_sigmoid(bf_hi(gw[0])); v0[2] *= fast_sigmoid(bf_lo(gw[1])); v0[3] *= fast_sigmoid(bf_hi(gw[1]));
                    v1[0] *= fast_sigmoid(bf_lo(gw[2])); v1[1] *= fast_sigmoid(bf_hi(gw[2])); v1[2] *= fast_sigmoid(bf_lo(gw[3])); v1[3] *= fast_sigmoid(bf_hi(gw[3]));
                    float* tp = T + r * DM + colb + bj * 128;
                    if (u.half == 0) { *(f32x4*)tp = v0; *(f32x4*)(tp + 4) = v1; }
                    else { v0 += *(const f32x4*)tp; v1 += *(const f32x4*)(tp + 4); *(u32x4*)(O + r * DM + colb + bj * 128) = pack8(v0, v1); }
                }
                asm volatile("" ::: "memory");
            }
    }
};

struct EpiResid {
    const float* xlat; const float* xctx;
    float* Xout; const float* gate;
    __device__ __forceinline__ void operator()(const f32x4 (&acc)[2][2][4][2], const Unit& u, int wr, int wc, int fr, int fq) const {
        const int row0 = u.pm * 256 + wr * 64 + fr, colb = u.pn * 256 + wc * 32 + 8 * fq;
        const float* g = gate + (size_t)row_b5(u.pm) * NMOD + colb;
        const float* xin = u.pm < 32 ? xlat : xctx - (size_t)MLAT * DM;
        f32x4 gv[2][2];
#pragma unroll
        for (int bj = 0; bj < 2; ++bj)
#pragma unroll
            for (int n = 0; n < 2; ++n) gv[bj][n] = *(const f32x4*)(g + bj * 128 + 4 * n);
#pragma unroll
        for (int ai = 0; ai < 2; ++ai)
#pragma unroll
            for (int m = 0; m < 4; ++m) {
                const size_t off = (size_t)(row0 + ai * 128 + m * 16) * DM + colb;
#pragma unroll
                for (int bj = 0; bj < 2; ++bj)
#pragma unroll
                    for (int n = 0; n < 2; ++n) { const f32x4 xi = *(const f32x4*)(xin + off + bj * 128 + 4 * n); *(f32x4*)(Xout + off + bj * 128 + 4 * n) = xi + gv[bj][n] * acc[ai][bj][m][n]; }
                asm volatile("" ::: "memory");
            }
    }
};

struct EpiSwiglu {
    bf16_t* O; int ldo;
    __device__ __forceinline__ void operator()(const f32x4 (&acc)[2][2][4][2], const Unit& u, int wr, int wc, int fr, int fq) const {
        const int row0 = u.pm * 256 + wr * 64 + fr, colb = u.pn * 128 + wc * 32 + 8 * fq;
#pragma unroll
        for (int ai = 0; ai < 2; ++ai)
#pragma unroll
            for (int m = 0; m < 4; ++m) {
                f32x4 v[2];
#pragma unroll
                for (int n = 0; n < 2; ++n)
#pragma unroll
                    for (int j = 0; j < 4; ++j) { const float a = acc[ai][0][m][n][j], b = acc[ai][1][m][n][j]; v[n][j] = a * fast_sigmoid(a) * b; }
                *(u32x4*)(O + (size_t)(row0 + ai * 128 + m * 16) * ldo + colb) = pack8(v[0], v[1]);
            }
    }
};

struct EpiDown {
    int mode; float* X; const float* gate; bf16_t* O;
    __device__ __forceinline__ void operator()(const f32x4 (&acc)[2][2][4][2], const Unit& u, int wr, int wc, int fr, int fq) const {
        const int row0 = u.pm * 256 + wr * 64 + fr, colb = u.pn * 256 + wc * 32 + 8 * fq;
        if (mode == 0) {
            const float* g = gate + (size_t)row_b5(u.pm) * NMOD + colb;
            f32x4 gv[2][2];
#pragma unroll
            for (int bj = 0; bj < 2; ++bj)
#pragma unroll
                for (int n = 0; n < 2; ++n) gv[bj][n] = *(const f32x4*)(g + bj * 128 + 4 * n);
#pragma unroll
            for (int ai = 0; ai < 2; ++ai)
#pragma unroll
                for (int m = 0; m < 4; ++m) {
                    const size_t off = (size_t)(row0 + ai * 128 + m * 16) * DM + colb;
#pragma unroll
                    for (int bj = 0; bj < 2; ++bj)
#pragma unroll
                        for (int n = 0; n < 2; ++n) { const f32x4 xi = *(const f32x4*)(X + off + bj * 128 + 4 * n); *(f32x4*)(X + off + bj * 128 + 4 * n) = xi + gv[bj][n] * acc[ai][bj][m][n]; }
                    asm volatile("" ::: "memory");
                }
        } else {
#pragma unroll
            for (int ai = 0; ai < 2; ++ai)
#pragma unroll
                for (int m = 0; m < 4; ++m) {
                    bf16_t* rowp = O + (size_t)(row0 + ai * 128 + m * 16) * DM + colb;
#pragma unroll
                    for (int bj = 0; bj < 2; ++bj) *(u32x4*)(rowp + bj * 128) = pack8(acc[ai][bj][m][0], acc[ai][bj][m][1]);
                }
        }
    }
};

namespace att {
constexpr int D = 128, NW = 8, QBLK = 32, KVBLK = 64;
constexpr float SCALE = 0.088388347648318440f;
constexpr float THR = 8.f;
constexpr int LDQ = PW, LDK = PW, LDO = 2 * DM;
constexpr int SHM_V = KVBLK * D * 2, SHM_K = KVBLK * D * 2, SHM_ATTN = 2 * SHM_V + 2 * SHM_K + NW * 64 * 4;
#define KSWZ(row, colB) ((row) * 256 + ((colB) ^ (((row) & 7) << 4)))
#define SBAR() __builtin_amdgcn_sched_barrier(0)
__device__ __forceinline__ int crow(int r, int hi) { return (r & 3) + 8 * (r >> 2) + 4 * hi; }
__device__ __forceinline__ unsigned cvtpk(float lo, float hi) { unsigned r; asm volatile("v_cvt_pk_bf16_f32 %0, %1, %2" : "=v"(r) : "v"(lo), "v"(hi)); return r; }

__device__ __forceinline__ void mask_tile(f32x16& p0, f32x16& p1, int dq) {
    const float NEG = -__builtin_inff();
#pragma unroll
    for (int r = 0; r < 16; ++r) {
        const int c = (r & 3) + 8 * (r >> 2);
        if ((unsigned)(dq - c) > 256u) p0[r] = NEG;
        if ((unsigned)(dq - c - 32) > 256u) p1[r] = NEG;
    }
}
__device__ __forceinline__ void partialSM(f32x16& p0, f32x16& p1, float& m_reg, float& mn, float& alpha) {
    constexpr float C = SCALE * 1.4426950408889634f;
    float pmax = p0[0];
#pragma unroll
    for (int r = 1; r < 16; ++r) pmax = fmaxf(pmax, p0[r]);
#pragma unroll
    for (int r = 0; r < 16; ++r) pmax = fmaxf(pmax, p1[r]);
    { auto rr = __builtin_amdgcn_permlane32_swap(__float_as_uint(pmax), __float_as_uint(pmax), false, false);
      pmax = fmaxf(__uint_as_float(rr[0]), __uint_as_float(rr[1])); }
    if (__builtin_expect(__all(pmax - m_reg <= THR / SCALE), 1)) { mn = m_reg; alpha = 1.f; }
    else { mn = fmaxf(m_reg, pmax); alpha = __builtin_amdgcn_exp2f((m_reg - mn) * C); m_reg = mn; }
    float mnC = -mn * C;
#pragma unroll
    for (int r = 0; r < 16; ++r) p0[r] = fmaf(p0[r], C, mnC);
#pragma unroll
    for (int r = 0; r < 16; ++r) p1[r] = fmaf(p1[r], C, mnC);
#pragma unroll
    for (int r = 0; r < 16; ++r) p0[r] = __builtin_amdgcn_exp2f(p0[r]);
}
__device__ __forceinline__ void finishSM(f32x16& p0, f32x16& p1, float alpha, float& l_reg, bf16x8& pa0, bf16x8& pa1, bf16x8& pa2, bf16x8& pa3) {
#pragma unroll
    for (int r = 0; r < 16; ++r) p1[r] = __builtin_amdgcn_exp2f(p1[r]);
    float ps = 0;
#pragma unroll
    for (int r = 0; r < 16; ++r) ps += p0[r];
#pragma unroll
    for (int r = 0; r < 16; ++r) ps += p1[r];
    { auto rr = __builtin_amdgcn_permlane32_swap(__float_as_uint(ps), __float_as_uint(ps), false, false);
      ps = __uint_as_float(rr[0]) + __uint_as_float(rr[1]); }
    l_reg = l_reg * alpha + ps;
#define PK4(P, BASE, OUT) do { unsigned a0 = cvtpk(P[BASE + 0], P[BASE + 1]), a1 = cvtpk(P[BASE + 2], P[BASE + 3]);   \
    unsigned b0 = cvtpk(P[BASE + 4], P[BASE + 5]), b1 = cvtpk(P[BASE + 6], P[BASE + 7]);                              \
    auto r0 = __builtin_amdgcn_permlane32_swap(a0, b0, false, false); auto r1 = __builtin_amdgcn_permlane32_swap(a1, b1, false, false); \
    u32x4 w = {r0[0], r1[0], r0[1], r1[1]}; OUT = *reinterpret_cast<bf16x8*>(&w); } while (0)
    PK4(p0, 0, pa0); PK4(p0, 8, pa1); PK4(p1, 0, pa2); PK4(p1, 8, pa3);
#undef PK4
}
__device__ __forceinline__ void qkt(f32x16& p0, f32x16& p1, const LAS char* Ks, const bf16x8* qr, int r32, int hi) {
    p0 = f32x16{}; p1 = f32x16{};
#pragma unroll
    for (int d0 = 0; d0 < 8; ++d0) { int cb = (d0 * 16 + hi * 8) * 2;
        bf16x8 b0 = *reinterpret_cast<const LAS bf16x8*>(Ks + KSWZ(r32, cb));
        bf16x8 b1 = *reinterpret_cast<const LAS bf16x8*>(Ks + KSWZ(32 + r32, cb));
        p0 = __builtin_amdgcn_mfma_f32_32x32x16_bf16(b0, qr[d0], p0, 0, 0, 0);
        p1 = __builtin_amdgcn_mfma_f32_32x32x16_bf16(b1, qr[d0], p1, 0, 0, 0); }
}
__device__ __forceinline__ int v_st(int k, int c) { const int kk = (k & ~0xC) | ((k & 4) << 1) | ((k & 8) >> 1); return ((kk >> 3) * 4 + (c >> 5)) * 512 + ((kk & 7) * 32 + (c & 31)) * 2; }
__device__ __forceinline__ int v_rd_base(int lane) { return ((lane & 3) << 3) | (((lane >> 2) & 3) << 6) | (((lane >> 4) & 1) << 5) | (((lane >> 5) & 1) << 8); }
constexpr int v_rd_off(int d0, int ks, int half) { return d0 * 512 + ks * 4096 + half * 2048; }
template <int OFF> __device__ __forceinline__ s16x4 tr_read(int vb) {
    s16x4 r; asm volatile("ds_read_b64_tr_b16 %0, %1 offset:%2" : "=&v"(r) : "v"(vb), "i"(OFF) : "memory"); return r;
}
template <int D0> __device__ __forceinline__ void pv_one(f32x16& od, int vb, bf16x8 pa0, bf16x8 pa1, bf16x8 pa2, bf16x8 pa3) {
    const s16x4 l0 = tr_read<v_rd_off(D0, 0, 0)>(vb), h0 = tr_read<v_rd_off(D0, 0, 1)>(vb), l1 = tr_read<v_rd_off(D0, 1, 0)>(vb), h1 = tr_read<v_rd_off(D0, 1, 1)>(vb);
    const s16x4 l2 = tr_read<v_rd_off(D0, 2, 0)>(vb), h2 = tr_read<v_rd_off(D0, 2, 1)>(vb), l3 = tr_read<v_rd_off(D0, 3, 0)>(vb), h3 = tr_read<v_rd_off(D0, 3, 1)>(vb);
    asm volatile("s_waitcnt lgkmcnt(0)" ::: "memory"); SBAR();
#define PK(L, H) (bf16x8){L[0], L[1], L[2], L[3], H[0], H[1], H[2], H[3]}
    od = __builtin_amdgcn_mfma_f32_32x32x16_bf16(pa0, PK(l0, h0), od, 0, 0, 0);
    od = __builtin_amdgcn_mfma_f32_32x32x16_bf16(pa1, PK(l1, h1), od, 0, 0, 0);
    od = __builtin_amdgcn_mfma_f32_32x32x16_bf16(pa2, PK(l2, h2), od, 0, 0, 0);
    od = __builtin_amdgcn_mfma_f32_32x32x16_bf16(pa3, PK(l3, h3), od, 0, 0, 0);
#undef PK
}
__device__ __forceinline__ void pv_d0(f32x16* o, int vb, bf16x8 pa0, bf16x8 pa1, bf16x8 pa2, bf16x8 pa3) {
    pv_one<0>(o[0], vb, pa0, pa1, pa2, pa3); pv_one<1>(o[1], vb, pa0, pa1, pa2, pa3); pv_one<2>(o[2], vb, pa0, pa1, pa2, pa3); pv_one<3>(o[3], vb, pa0, pa1, pa2, pa3);
}

struct Call {
    const bf16_t* Pb;
    bf16_t* Y;
    int qrow0;
    int head0;
    int kvh;
    int krow_c, nt_c;
    int krow_l, nt_l;
    int qpos0, kpos0;
    const float* sink;
    int lat;
};

__device__ __forceinline__ void attn_call(const Call& c, LAS char* lds) {
    int tid_ = threadIdx.x; asm volatile("" : "+v"(tid_));
    const int tid = tid_, wid = __builtin_amdgcn_readfirstlane(tid >> 6), lane = tid & 63, r32 = lane & 31, hi = lane >> 5;
    LAS char* V_lds = lds; LAS char* K_lds = lds + 2 * SHM_V;
    LAS float* ws = (LAS float*)(lds + 2 * SHM_V + 2 * SHM_K) + wid * 64; LAS float* li_l = ws; LAS float* al_l = ws + 32;
    const int wpos = c.lat ? (wid & 3) : wid, head = c.head0 + (c.lat ? (wid >> 2) : 0);
    float m_reg = -1e30f, l_reg = 0; f32x16 o[4] = {}; bf16x8 qr[8];
    const bf16_t* Qw = c.Pb + (size_t)(c.qrow0 + wpos * QBLK + r32) * LDQ + head * D + hi * 8;
#pragma unroll
    for (int d0 = 0; d0 < 8; ++d0) qr[d0] = *reinterpret_cast<const bf16x8*>(Qw + d0 * 16);
    const int sr = tid >> 4, sc = (tid & 15) * 8, vst0 = v_st(sr, sc), vst1 = v_st(32 + sr, sc);
    const int vb0 = (int)(uintptr_t)V_lds + v_rd_base(lane);
    const bf16_t* Kc = c.Pb + (size_t)c.krow_c * LDK + COL_K + c.kvh * D + (size_t)sr * LDK + sc;
    const bf16_t* Kl = c.Pb + (size_t)c.krow_l * LDK + COL_K + c.kvh * D + (size_t)sr * LDK + sc;
    const int NT = c.nt_c + c.nt_l, ntc = c.nt_c;
    const int dq0 = (c.qpos0 + wpos * QBLK + r32) - c.kpos0 - 4 * hi + 128;
    struct { bf16x8 vs0, vs1, ks0, ks1; } sr_[2];
#define TILEP(j) (((j) < ntc) ? (Kc + (size_t)(j) * (KVBLK * LDK)) : (Kl + (size_t)((j) - ntc) * (KVBLK * LDK)))
#define SLOAD(i, j) do { const bf16_t* kp_ = TILEP(j); sr_[i].vs0 = *reinterpret_cast<const bf16x8*>(kp_ + (COL_V - COL_K)); sr_[i].vs1 = *reinterpret_cast<const bf16x8*>(kp_ + (COL_V - COL_K) + (size_t)32 * LDK); \
    sr_[i].ks0 = *reinterpret_cast<const bf16x8*>(kp_); sr_[i].ks1 = *reinterpret_cast<const bf16x8*>(kp_ + (size_t)32 * LDK); } while (0)
#define SWRITE(b, i) do { *(LAS bf16x8*)(V_lds + (b) * SHM_V + vst0) = sr_[i].vs0;          \
    *(LAS bf16x8*)(V_lds + (b) * SHM_V + vst1) = sr_[i].vs1; int kc = sc * 2;               \
    *(LAS bf16x8*)(K_lds + (b) * SHM_K + KSWZ(sr, kc)) = sr_[i].ks0;                       \
    *(LAS bf16x8*)(K_lds + (b) * SHM_K + KSWZ(32 + sr, kc)) = sr_[i].ks1; } while (0)
#define SWAIT() asm volatile("s_waitcnt vmcnt(4)" ::: "memory")
#define RESC(a) do { if (__any((a) < 1.f)) { if (hi == 0) al_l[r32] = (a); asm volatile("s_waitcnt lgkmcnt(0)" ::: "memory"); \
    _Pragma("unroll") for (int d = 0; d < 4; ++d) _Pragma("unroll") for (int r = 0; r < 16; ++r) o[d][r] *= al_l[crow(r, hi)]; } } while (0)
#define MASK(P0, P1, j) do { if ((j) >= ntc) { const int jl_ = (j) - ntc; const int kb_ = c.kpos0 + 64 * jl_; \
    if (kb_ + 63 > c.qpos0 + 128 || kb_ < c.qpos0 + 127 - 128) mask_tile(P0, P1, dq0 - 64 * jl_); } } while (0)
    f32x16 pA0, pA1, pB0, pB1; float mnA, mnB, alA, alB; bf16x8 pa0, pa1, pa2, pa3;
    constexpr int SE = 0, SO = 1;
    SLOAD(SE, 0); asm volatile("s_waitcnt vmcnt(0)" ::: "memory"); SWRITE(0, SE); __syncthreads();
    qkt(pA0, pA1, K_lds, qr, r32, hi); MASK(pA0, pA1, 0); partialSM(pA0, pA1, m_reg, mnA, alA);
    SLOAD(SO, 1); if (2 < NT) SLOAD(SE, 2);
    SWAIT(); SWRITE(1, SO); __syncthreads();
    for (int j = 1; j + 1 < NT; j += 2) {
        SBAR(); qkt(pB0, pB1, K_lds + SHM_K, qr, r32, hi);
        finishSM(pA0, pA1, alA, l_reg, pa0, pa1, pa2, pa3); SBAR();
        SLOAD(SO, j + 2); SBAR();
        pv_d0(o, vb0, pa0, pa1, pa2, pa3); MASK(pB0, pB1, j); partialSM(pB0, pB1, m_reg, mnB, alB);
        __syncthreads(); SWAIT(); SWRITE(0, SE);
        RESC(alB); __syncthreads();
        SBAR(); qkt(pA0, pA1, K_lds, qr, r32, hi);
        finishSM(pB0, pB1, alB, l_reg, pa0, pa1, pa2, pa3); SBAR();
        if (j + 3 < NT) SLOAD(SE, j + 3); SBAR();
        pv_d0(o, vb0 + (int)SHM_V, pa0, pa1, pa2, pa3); MASK(pA0, pA1, j + 1); partialSM(pA0, pA1, m_reg, mnA, alA);
        __syncthreads(); SWAIT(); SWRITE(1, SO);
        RESC(alA); __syncthreads();
    }
    SBAR(); qkt(pB0, pB1, K_lds + SHM_K, qr, r32, hi);
    finishSM(pA0, pA1, alA, l_reg, pa0, pa1, pa2, pa3); SBAR();
    pv_d0(o, vb0, pa0, pa1, pa2, pa3); MASK(pB0, pB1, NT - 1); partialSM(pB0, pB1, m_reg, mnB, alB);
    __syncthreads(); RESC(alB);
    finishSM(pB0, pB1, alB, l_reg, pa0, pa1, pa2, pa3); SBAR();
    pv_d0(o, vb0 + (int)SHM_V, pa0, pa1, pa2, pa3);
    l_reg += __builtin_amdgcn_exp2f(c.sink[head] * 1.4426950408889634f - m_reg * (SCALE * 1.4426950408889634f));
    if (hi == 0) li_l[r32] = l_reg; asm volatile("s_waitcnt lgkmcnt(0)" ::: "memory");
    float rli[16];
#pragma unroll
    for (int r = 0; r < 16; ++r) rli[r] = __builtin_amdgcn_rcpf(li_l[crow(r, hi)]);
    bf16_t* Ow = c.Y + (size_t)(c.qrow0 + wpos * QBLK) * LDO + head * D;
#pragma unroll
    for (int r = 0; r < 16; ++r) { const int orow = crow(r, hi);
#pragma unroll
        for (int d0 = 0; d0 < 4; ++d0) { const unsigned w = cvtpk(o[d0][r] * rli[r], 0.f); Ow[(size_t)orow * LDO + d0 * 32 + r32] = (bf16_t)(w & 0xffffu); } }
    __syncthreads();
#undef TILEP
#undef SLOAD
#undef SWRITE
#undef SWAIT
#undef RESC
#undef MASK
}
#undef KSWZ
#undef SBAR
}

constexpr int NWAVES = 8;
struct Args {
    const float* x; const float* c; const float* ctx; const float* c_ctx; const float* w_mod; const float* b_mod; const float* norm1; const float* w_in; const float* sink; const float* conv_w;
    const float* w_o_attn; const float* w_o_conv; const float* w_out; const float* norm2; const float* ffn_w1; const float* ffn_w3; const float* ffn_w2; const float* router;
    const float* moe_w1; const float* moe_w3; const float* moe_w2; const float* norm_f;
    float* out; unsigned char* ws; int ph_lo, ph_hi;
};

struct CvtJob { const float* W; bf16_t* WT; int K, N, ldk, koff, mode; };
__device__ __forceinline__ int cvt_row(int mode, int n0, int jn) {
    if (mode == 1 && n0 < 2560) { const int t256 = n0 & ~255, blk64 = (n0 & 255) >> 6; return t256 + 128 * (jn >> 5) + 32 * blk64 + (jn & 31); }
    if (mode >= 2) { const int pn = n0 >> 7, t = (n0 & 127) + jn; return 256 * pn + 128 * (mode - 2) + t; }
    return n0 + jn;
}
__device__ __forceinline__ void cvt_load(const CvtJob& J, int item, int lane, f32x4 (&v)[16]) {
    const int nblk = J.N >> 6, kb = item / nblk, nb = item - kb * nblk;
    const float* src = J.W + (size_t)(kb * 64 + (lane >> 4)) * J.N + nb * 64 + 4 * (lane & 15);
#pragma unroll
    for (int i = 0; i < 16; ++i) v[i] = __builtin_nontemporal_load((const f32x4*)(src + (size_t)(4 * i) * J.N));
}
__device__ __forceinline__ void cvt_store(const CvtJob& J, int item, int lane, const f32x4 (&v)[16], LAS float* scr) {
    const int nblk = J.N >> 6, kb = item / nblk, nb = item - kb * nblk, k0 = kb * 64, n0 = nb * 64;
#pragma unroll
    for (int i = 0; i < 16; ++i) { LAS float* d = scr + (4 * i + (lane >> 4)) * 65 + 4 * (lane & 15); d[0] = v[i][0]; d[1] = v[i][1]; d[2] = v[i][2]; d[3] = v[i][3]; }
    LDS_WAIT();
    const int cch = lane & 7;
#pragma unroll
    for (int j = 0; j < 8; ++j) { const int jn = (lane >> 3) + 8 * j; const LAS float* s = scr + (8 * cch) * 65 + jn;
        u32x4 o; o.x = cvt_pk_bf16(s[0 * 65], s[1 * 65]); o.y = cvt_pk_bf16(s[2 * 65], s[3 * 65]); o.z = cvt_pk_bf16(s[4 * 65], s[5 * 65]); o.w = cvt_pk_bf16(s[6 * 65], s[7 * 65]);
        *(u32x4*)(J.WT + (size_t)cvt_row(J.mode, n0, jn) * J.ldk + J.koff + k0 + 8 * cch) = o; }
    LDS_WAIT();
}
__device__ __forceinline__ bool cvt_decode(const Args& a, int it, CvtJob& J, int& local) {
    unsigned char* ws = a.ws;
    if (it < 2 * 9728) { const int l = it / 9728; int r = it - l * 9728;
        if (r < 6656) { J = CvtJob{a.w_in + (size_t)l * DM * PW, (bf16_t*)(ws + WS_WIN) + (size_t)l * PW * DM, DM, PW, DM, 0, 1}; local = r; return true; } r -= 6656;
        if (r < 1024) { J = CvtJob{a.w_o_attn + (size_t)l * DM * DM, (bf16_t*)(ws + WS_WMG) + (size_t)l * DM * 2 * DM, DM, DM, 2 * DM, 0, 0}; local = r; return true; } r -= 1024;
        if (r < 1024) { J = CvtJob{a.w_o_conv + (size_t)l * DM * DM, (bf16_t*)(ws + WS_WMG) + (size_t)l * DM * 2 * DM, DM, DM, 2 * DM, DM, 0}; local = r; return true; } r -= 1024;
        J = CvtJob{a.w_out + (size_t)l * DM * DM, (bf16_t*)(ws + WS_WOUT) + (size_t)l * DM * DM, DM, DM, DM, 0, 0}; local = r; return true; }
    it -= 2 * 9728;
    if (it < 3 * 2816) { const int w = it / 2816; local = it - w * 2816;
        if (w == 0) J = CvtJob{a.ffn_w1, (bf16_t*)(ws + WS_WF13), DM, DFF, DM, 0, 2};
        else if (w == 1) J = CvtJob{a.ffn_w3, (bf16_t*)(ws + WS_WF13), DM, DFF, DM, 0, 3};
        else J = CvtJob{a.ffn_w2, (bf16_t*)(ws + WS_WF2), DFF, DM, DFF, 0, 0};
        return true; }
    it -= 3 * 2816;
    if (it < NE * 3 * 3584) { const int e = it / (3 * 3584); int r = it - e * 3 * 3584; const int w = r / 3584; local = r - w * 3584;
        if (w == 0) J = CvtJob{a.moe_w1 + (size_t)e * DM * DFE, (bf16_t*)(ws + WS_WM13) + (size_t)e * 2 * DFE * DM, DM, DFE, DM, 0, 2};
        else if (w == 1) J = CvtJob{a.moe_w3 + (size_t)e * DM * DFE, (bf16_t*)(ws + WS_WM13) + (size_t)e * 2 * DFE * DM, DM, DFE, DM, 0, 3};
        else J = CvtJob{a.moe_w2 + (size_t)e * DFE * DM, (bf16_t*)(ws + WS_WM2) + (size_t)e * DM * DFE, DFE, DM, DFE, 0, 0};
        return true; }
    return false;
}
constexpr int CVT_ITEMS = 2 * 9728 + 3 * 2816 + NE * 3 * 3584;

__device__ __forceinline__ float silu_f(float x) { return x / (1.0f + __expf(-x)); }

__device__ __forceinline__ void phase_prologue(const Args& a, LAS unsigned char* lds, int gw, int NGW, int wave, int lane) {
    unsigned char* ws = a.ws;
    const int tid = threadIdx.x;
    if (blockIdx.x == 0) {
        float* rt = (float*)(ws + WS_ROPE);
        for (int e = tid; e < 64 * 32; e += NWAVES * 64) { const int p = e >> 5, i = e & 31;
            const float inv = __builtin_amdgcn_exp2f(-(float)i * (13.287712379549449f / 32.0f)); const float ang = (float)p * inv;
            float rev = ang * 0.15915494309189535f; rev -= floorf(rev);
            rt[e] = __builtin_amdgcn_cosf(rev); rt[64 * 32 + e] = __builtin_amdgcn_sinf(rev); }
    }
    LAS float* act = (LAS float*)lds;
    for (int e = tid; e < 5 * DM; e += NWAVES * 64) { const int b = e >> 11, k = e & (DM - 1); act[e] = silu_f(b < 4 ? a.c[b * DM + k] : a.c_ctx[k]); }
    __syncthreads();
    constexpr int MOD_ITEMS = 2 * 48 * KS_MOD;
    for (int it = gw; it < MOD_ITEMS; it += NGW) {
        const int kc = it % KS_MOD, cc = (it / KS_MOD) % 48, l = it / (KS_MOD * 48);
        const float* W = a.w_mod + (size_t)l * DM * NMOD + (size_t)(kc * 128) * NMOD + cc * 256 + 4 * lane;
        f32x4 s[5];
#pragma unroll
        for (int b = 0; b < 5; ++b) s[b] = (f32x4){0.f, 0.f, 0.f, 0.f};
#pragma unroll 2
        for (int k8 = 0; k8 < 16; ++k8) {
            f32x4 w[8];
#pragma unroll
            for (int i = 0; i < 8; ++i) w[i] = __builtin_nontemporal_load((const f32x4*)(W + (size_t)(k8 * 8 + i) * NMOD));
#pragma unroll
            for (int b = 0; b < 5; ++b) { const f32x4 a0 = *(const LAS f32x4*)(act + b * DM + kc * 128 + k8 * 8), a1 = *(const LAS f32x4*)(act + b * DM + kc * 128 + k8 * 8 + 4);
                s[b] += w[0] * a0[0]; s[b] += w[1] * a0[1]; s[b] += w[2] * a0[2]; s[b] += w[3] * a0[3];
                s[b] += w[4] * a1[0]; s[b] += w[5] * a1[1]; s[b] += w[6] * a1[2]; s[b] += w[7] * a1[3]; }
        }
        float* mp = (float*)(ws + WS_MODP) + ((size_t)(kc * 2 + l) * 5) * NMOD + cc * 256 + 4 * lane;
#pragma unroll
        for (int b = 0; b < 5; ++b) *(f32x4*)(mp + (size_t)b * NMOD) = s[b];
    }
    __syncthreads();
    LAS float* scr = (LAS float*)(lds + wave * 16640);
    f32x4 v[16], vn[16]; CvtJob J, Jn; int loc = 0, locn = 0;
    int it = gw; bool have = (it < CVT_ITEMS) && cvt_decode(a, it, J, loc);
    if (have) cvt_load(J, loc, lane, v);
    while (have) {
        const int itn = it + NGW; const bool haven = (itn < CVT_ITEMS) && cvt_decode(a, itn, Jn, locn);
        if (haven) cvt_load(Jn, locn, lane, vn);
        cvt_store(J, loc, lane, v, scr);
        if (haven) {
#pragma unroll
            for (int i = 0; i < 16; ++i) v[i] = vn[i];
            J = Jn; loc = locn; }
        it = itn; have = haven;
    }
}

__device__ __forceinline__ void phase_modreduce(const Args& a) {
    unsigned char* ws = a.ws;
    const float* mp = (const float*)(ws + WS_MODP); float* mt = (float*)(ws + WS_MODT);
    for (int e = blockIdx.x * (NWAVES * 64) + threadIdx.x; e < 2 * 5 * DM; e += gridDim.x * NWAVES * 64) {
        const int c = e & (DM - 1), b = (e >> 11) % 5, l = e / (5 * DM);
        float m[6];
#pragma unroll
        for (int s = 0; s < 6; ++s) { float acc = a.b_mod[l * NMOD + s * DM + c];
            for (int kc = 0; kc < KS_MOD; ++kc) acc += mp[((size_t)(kc * 2 + l) * 5 + b) * NMOD + s * DM + c];
            m[s] = acc; }
        float* o = mt + ((size_t)(l * 5 + b) * 6) * DM + c;
        o[0 * DM] = a.norm1[l * DM + c] * (1.0f + m[1]); o[1 * DM] = m[0]; o[2 * DM] = m[2];
        o[3 * DM] = a.norm2[l * DM + c] * (1.0f + m[4]); o[4 * DM] = m[3]; o[5 * DM] = m[5];
    }
}

__device__ __forceinline__ void norm_row(const float* xrow, const float* A, const float* B, bf16_t* orow, int lane, f32x4 (&hv)[8]) {
    const f32x4* xr = (const f32x4*)xrow + lane; float ss = 0.f;
#pragma unroll
    for (int j = 0; j < 8; ++j) { hv[j] = xr[64 * j]; ss += (hv[j][0] * hv[j][0] + hv[j][1] * hv[j][1]) + (hv[j][2] * hv[j][2] + hv[j][3] * hv[j][3]); }
    const float rstd = 1.0f / sqrtf(wave_sum(ss) * (1.0f / DM) + RMS_EPS);
    const f32x4* ar = (const f32x4*)A + lane; const f32x4* br = (const f32x4*)B + lane;
    u32x2* o8 = (u32x2*)orow + lane;
#pragma unroll
    for (int j = 0; j < 8; ++j) { hv[j] = hv[j] * rstd * ar[64 * j] + br[64 * j]; u32x2 w; w.x = cvt_pk_bf16(hv[j][0], hv[j][1]); w.y = cvt_pk_bf16(hv[j][2], hv[j][3]); o8[64 * j] = w; }
}
__device__ __forceinline__ void phase_norm(const Args& a, int layer, int slotA, int nrows, int gw, int NGW, int lane) {
    unsigned char* ws = a.ws;
    const float* mt = (const float*)(ws + WS_MODT) + (size_t)layer * 5 * NMOD; bf16_t* H = (bf16_t*)(ws + WS_H); const float* X = (const float*)(ws + WS_X);
    const bool from_in = (layer == 0 && slotA == 0);
    for (int r = gw; r < nrows; r += NGW) {
        const int b5 = r < MLAT ? (r >> 11) : 4;
        const float* xrow = from_in ? (r < MLAT ? a.x + (size_t)r * DM : a.ctx + (size_t)(r - MLAT) * DM) : X + (size_t)r * DM;
        f32x4 hv[8];
        norm_row(xrow, mt + (size_t)b5 * NMOD + slotA * DM, mt + (size_t)b5 * NMOD + (slotA + 1) * DM, H + (size_t)r * DM, lane, hv);
    }
}

__device__ __forceinline__ void unpack8(const u32x4 w, float (&f)[8]) { f[0] = bf_lo(w.x); f[1] = bf_hi(w.x); f[2] = bf_lo(w.y); f[3] = bf_hi(w.y); f[4] = bf_lo(w.z); f[5] = bf_hi(w.z); f[6] = bf_lo(w.w); f[7] = bf_hi(w.w); }
__device__ __forceinline__ void phase_conv(const Args& a, int layer, int nrows) {
    unsigned char* ws = a.ws; const bf16_t* P = (const bf16_t*)(ws + WS_R1); bf16_t* Y = (bf16_t*)(ws + WS_Y);
    const float* cw = a.conv_w + (size_t)layer * 3 * DM;
    const int ntask = (nrows / 16) * 256;
    for (int t = blockIdx.x * (NWAVES * 64) + threadIdx.x; t < ntask; t += gridDim.x * NWAVES * 64) {
        const int cg = t & 255, rc = t >> 8, r0 = rc * 16, c0 = cg * 8;
        const int seqlen = r0 < MLAT ? SEQ : CTX; const int s0 = r0 < MLAT ? (r0 & (SEQ - 1)) : ((r0 - MLAT) & (CTX - 1));
        float w0[8], w1[8], w2[8];
#pragma unroll
        for (int i = 0; i < 8; ++i) { w0[i] = cw[c0 + i]; w1[i] = cw[DM + c0 + i]; w2[i] = cw[2 * DM + c0 + i]; }
        float zp[8], zc[8], zn[8];
        const bf16_t* base = P + (size_t)r0 * PW + c0;
        if (s0 > 0) { float u[8], g[8]; unpack8(*(const u32x4*)(base - PW + COL_U), u); unpack8(*(const u32x4*)(base - PW + COL_GC), g);
#pragma unroll
            for (int i = 0; i < 8; ++i) zp[i] = u[i] * g[i]; }
        else {
#pragma unroll
            for (int i = 0; i < 8; ++i) zp[i] = 0.f; }
        { float u[8], g[8]; unpack8(*(const u32x4*)(base + COL_U), u); unpack8(*(const u32x4*)(base + COL_GC), g);
#pragma unroll
            for (int i = 0; i < 8; ++i) zc[i] = u[i] * g[i]; }
#pragma unroll 4
        for (int rr = 0; rr < 16; ++rr) {
            const bf16_t* rp = base + (size_t)rr * PW;
            if (s0 + rr + 1 < seqlen) { float u[8], g[8]; unpack8(*(const u32x4*)(rp + PW + COL_U), u); unpack8(*(const u32x4*)(rp + PW + COL_GC), g);
#pragma unroll
                for (int i = 0; i < 8; ++i) zn[i] = u[i] * g[i]; }
            else {
#pragma unroll
                for (int i = 0; i < 8; ++i) zn[i] = 0.f; }
            float gb[8]; unpack8(*(const u32x4*)(rp + COL_GB), gb);
            f32x4 o0, o1;
#pragma unroll
            for (int i = 0; i < 4; ++i) { o0[i] = gb[i] * (w0[i] * zp[i] + w1[i] * zc[i] + w2[i] * zn[i]); o1[i] = gb[4 + i] * (w0[4 + i] * zp[4 + i] + w1[4 + i] * zc[4 + i] + w2[4 + i] * zn[4 + i]); }
            *(u32x4*)(Y + (size_t)(r0 + rr) * (2 * DM) + DM + c0) = pack8(o0, o1);
#pragma unroll
            for (int i = 0; i < 8; ++i) { zp[i] = zc[i]; zc[i] = zn[i]; }
        }
    }
}

__device__ __forceinline__ void phase_norm2_router(const Args& a, LAS unsigned char* lds, int wave, int lane) {
    unsigned char* ws = a.ws; const int tid = threadIdx.x;
    const float* mt = (const float*)(ws + WS_MODT) + (size_t)1 * 5 * NMOD; bf16_t* H = (bf16_t*)(ws + WS_H); const float* X = (const float*)(ws + WS_X);
    int* mi = (int*)(ws + WS_MOEI);
    LAS float* rT = (LAS float*)lds;
    LAS int* lcnt = (LAS int*)(lds + 8 * DM * 4);
    for (int e = tid; e < DM * NE; e += NWAVES * 64) { const int k = e >> 3, ex = e & 7; rT[ex * DM + k] = a.router[e]; }
    for (int tb = blockIdx.x; tb < MLAT / 32; tb += gridDim.x) {
        if (tid < 8) lcnt[tid] = 0;
        __syncthreads();
        for (int q = 0; q < 4; ++q) {
            const int r = tb * 32 + wave * 4 + q, b5 = r >> 11;
            f32x4 hv[8];
            norm_row(X + (size_t)r * DM, mt + (size_t)b5 * NMOD + 3 * DM, mt + (size_t)b5 * NMOD + 4 * DM, H + (size_t)r * DM, lane, hv);
            float lg[8];
#pragma unroll
            for (int ex = 0; ex < 8; ++ex) { float s = 0.f;
#pragma unroll
                for (int j = 0; j < 8; ++j) { const f32x4 w = *(const LAS f32x4*)(rT + ex * DM + 256 * j + 4 * lane); s += (hv[j][0] * w[0] + hv[j][1] * w[1]) + (hv[j][2] * w[2] + hv[j][3] * w[3]); }
                lg[ex] = wave_sum(s); }
            int i0 = 0; float v0 = lg[0];
#pragma unroll
            for (int ex = 1; ex < 8; ++ex) if (lg[ex] > v0) { v0 = lg[ex]; i0 = ex; }
            int i1 = -1; float v1 = -3.0e38f;
#pragma unroll
            for (int ex = 0; ex < 8; ++ex) if (ex != i0 && lg[ex] > v1) { v1 = lg[ex]; i1 = ex; }
            const float e1 = __expf(v1 - v0), p0 = 1.0f / (1.0f + e1), p1 = e1 * p0;
            if (lane == 0) { mi[MI_TOKE + 2 * r] = i0; mi[MI_TOKE + 2 * r + 1] = i1; ((float*)mi)[MI_TOKP + 2 * r] = p0; ((float*)mi)[MI_TOKP + 2 * r + 1] = p1;
                __hip_atomic_fetch_add(&lcnt[i0], 1, __ATOMIC_RELAXED, __HIP_MEMORY_SCOPE_WORKGROUP); __hip_atomic_fetch_add(&lcnt[i1], 1, __ATOMIC_RELAXED, __HIP_MEMORY_SCOPE_WORKGROUP); }
        }
        __syncthreads();
        if (tid < 8) mi[MI_CNTWG + tb * 8 + tid] = lcnt[tid];
        __syncthreads();
    }
}

__device__ __forceinline__ void phase_moe_assign(const Args& a, LAS unsigned char* lds, int wave, int lane, int gw, int NGW) {
    unsigned char* ws = a.ws; const int tid = threadIdx.x;
    int* mi = (int*)(ws + WS_MOEI); const bf16_t* H = (const bf16_t*)(ws + WS_H); bf16_t* AS = (bf16_t*)(ws + WS_AS);
    LAS int* carr = (LAS int*)lds;
    LAS int* tot = carr + 2048;
    LAS int* base = tot + 8;
    LAS int* slots = base + 16;
    LAS int* pre = slots + 64;
    for (int e = tid; e < 2048; e += NWAVES * 64) carr[e] = mi[MI_CNTWG + e];
    __syncthreads();
    if (tid < 8) { int s = 0; for (int w = 0; w < 256; ++w) s += carr[w * 8 + tid]; tot[tid] = s; }
    __syncthreads();
    if (tid == 0) { int b = 0; for (int e = 0; e < 8; ++e) { base[e] = b; b += (tot[e] + 255) & ~255; } base[8] = b;
        if (blockIdx.x == 0) { int p = 0; for (int e = 0; e < 8; ++e) { const int np = ((tot[e] + 255) >> 8); for (int q = 0; q < np; ++q) mi[MI_PANE + p++] = e; } mi[MI_NPAN] = p; } }
    __syncthreads();
    for (int tb = blockIdx.x; tb < MLAT / 32; tb += gridDim.x) {
        if (tid < 8) { int s = 0; for (int w = 0; w < tb; ++w) s += carr[w * 8 + tid]; pre[tid] = s; }
        __syncthreads();
        if (wave == 0) {
            const int tok = tb * 32 + (lane >> 1), k = lane & 1, e = mi[MI_TOKE + 2 * tok + k];
            int rank = 0;
#pragma unroll
            for (int ex = 0; ex < 8; ++ex) { const unsigned long long m = __ballot(e == ex); if (e == ex) rank = __popcll(m & ((1ull << lane) - 1ull)); }
            const int slot = base[e] + pre[e] + rank;
            slots[lane] = slot; mi[MI_SLOT + 2 * tok + k] = slot;
        }
        __syncthreads();
        for (int p = wave * 8; p < wave * 8 + 8; ++p) {
            const int tok = tb * 32 + (p >> 1), slot = slots[p];
            const u32x4* src = (const u32x4*)(H + (size_t)tok * DM) + lane; u32x4* dst = (u32x4*)(AS + (size_t)slot * DM) + lane;
#pragma unroll
            for (int j = 0; j < 4; ++j) dst[64 * j] = src[64 * j];
        }
        __syncthreads();
    }
    for (int e = 0; e < 8; ++e) { const int first = base[e] + tot[e], npad = base[e + 1] - first;
        for (int i = gw; i < npad; i += NGW) { u32x4* dst = (u32x4*)(AS + (size_t)(first + i) * DM) + lane;
#pragma unroll
            for (int j = 0; j < 4; ++j) dst[64 * j] = (u32x4){0u, 0u, 0u, 0u}; } }
}

__device__ __forceinline__ void phase_combine(const Args& a, int gw, int NGW, int lane) {
    unsigned char* ws = a.ws; const int* mi = (const int*)(ws + WS_MOEI); const float* X = (const float*)(ws + WS_X); const bf16_t* OS = (const bf16_t*)(ws + WS_OS);
    const float* mt = (const float*)(ws + WS_MODT) + (size_t)1 * 5 * NMOD;
    for (int r = gw; r < MLAT; r += NGW) {
        const int b5 = r >> 11; const int s0 = mi[MI_SLOT + 2 * r], s1 = mi[MI_SLOT + 2 * r + 1]; const float p0 = ((const float*)mi)[MI_TOKP + 2 * r], p1 = ((const float*)mi)[MI_TOKP + 2 * r + 1];
        const f32x4* xr = (const f32x4*)(X + (size_t)r * DM) + lane; const f32x4* gr = (const f32x4*)(mt + (size_t)b5 * NMOD + 5 * DM) + lane;
        const u32x2* o0 = (const u32x2*)(OS + (size_t)s0 * DM) + lane; const u32x2* o1 = (const u32x2*)(OS + (size_t)s1 * DM) + lane;
        f32x4 v[8]; float ss = 0.f;
#pragma unroll
        for (int j = 0; j < 8; ++j) { const u32x2 w0 = o0[64 * j], w1 = o1[64 * j]; const f32x4 g = gr[64 * j];
            f32x4 m; m[0] = p0 * bf_lo(w0.x) + p1 * bf_lo(w1.x); m[1] = p0 * bf_hi(w0.x) + p1 * bf_hi(w1.x); m[2] = p0 * bf_lo(w0.y) + p1 * bf_lo(w1.y); m[3] = p0 * bf_hi(w0.y) + p1 * bf_hi(w1.y);
            v[j] = xr[64 * j] + g * m; ss += (v[j][0] * v[j][0] + v[j][1] * v[j][1]) + (v[j][2] * v[j][2] + v[j][3] * v[j][3]); }
        const float rstd = 1.0f / sqrtf(wave_sum(ss) * (1.0f / DM) + RMS_EPS);
        const f32x4* nf = (const f32x4*)a.norm_f + lane; f32x4* orow = (f32x4*)(a.out + (size_t)r * DM) + lane;
#pragma unroll
        for (int j = 0; j < 8; ++j) orow[64 * j] = v[j] * rstd * nf[64 * j];
    }
}

__device__ __forceinline__ void phase_attn(const Args& a, int layer, LAS unsigned char* lds) {
    unsigned char* ws = a.ws; const bf16_t* P = (const bf16_t*)(ws + WS_R1); bf16_t* Y = (bf16_t*)(ws + WS_Y);
    const float* sink = a.sink + layer * NH;
    for (int vw = blockIdx.x; vw < NB * NKV * 16; vw += gridDim.x) {
        const int n = vw & 15, kvh = (vw >> 4) & 3, b = vw >> 6;
        const int kb0 = n > 0 ? n - 1 : 0, kb1 = n < 15 ? n + 1 : 15;
        const int ncall = (layer == 0 && (n == 0 || n == 15)) ? 4 : 2;
        for (int k = 0; k < ncall; ++k) {
            att::Call c; c.Pb = P; c.Y = Y; c.sink = sink; c.nt_c = 4;
            if (k < 2) { c.qrow0 = b * SEQ + n * 128; c.head0 = kvh * 4 + k * 2; c.kvh = kvh; c.krow_c = MLAT + b * CTX;
                c.krow_l = b * SEQ + kb0 * 128; c.nt_l = (kb1 - kb0 + 1) * 2; c.qpos0 = n * 128; c.kpos0 = kb0 * 128; c.lat = 1; }
            else { const int id = ((vw >> 4) * 2 + (n == 15 ? 1 : 0)) * 2 + (k - 2), cb = id >> 4, head = id & 15;
                c.qrow0 = MLAT + cb * CTX; c.head0 = head; c.kvh = head >> 2; c.krow_c = MLAT + cb * CTX; c.krow_l = 0; c.nt_l = 0; c.qpos0 = 0; c.kpos0 = 0; c.lat = 0; }
            att::attn_call(c, (LAS char*)lds);
        }
    }
    phase_conv(a, layer, layer == 0 ? MALL : MLAT);
}

constexpr int N_PHASES = 22;
#ifndef PH_EN
#define PH_EN 0xFFFFFFFFu
#endif
#define EN(bit) ((PH_EN >> (bit)) & 1u)
#define IN(k) (lo <= (k) && (k) < hi)
#define SEAM(k) do { if (!MK_SPLIT && IN((k) + 1)) xcd_barrier(bar); } while (0)

template <int layer>
__device__ __forceinline__ void run_layer(const Args& a, LAS unsigned char* lds, const XcdBarrier& bar, const int lo, const int hi) {
    const int tid = threadIdx.x, lane = tid & 63, wave = __builtin_amdgcn_readfirstlane(tid >> 6);
    const int G = gridDim.x, gw = blockIdx.x * NWAVES + wave, NGW = G * NWAVES;
    unsigned char* ws = a.ws;
    bf16_t* const H = (bf16_t*)(ws + WS_H); float* const X = (float*)(ws + WS_X); bf16_t* const R1 = (bf16_t*)(ws + WS_R1);
    bf16_t* const Y = (bf16_t*)(ws + WS_Y); bf16_t* const MB = (bf16_t*)(ws + WS_MB);
    const float* const rope = (const float*)(ws + WS_ROPE);
    const int* const mi = (const int*)(ws + WS_MOEI);
    constexpr int pb = 2 + 10 * layer;
    constexpr int nM = layer == 0 ? MALL / 256 : MLAT / 256;
    const float* const mt = (const float*)(ws + WS_MODT) + (size_t)layer * 5 * NMOD;
    if (EN(2) && IN(pb + 0)) { phase_norm(a, layer, 0, MALL, gw, NGW, lane); SEAM(pb + 0); }
    if (EN(3) && IN(pb + 1)) {
        pg8::Order S; S.init(H, (const bf16_t*)(ws + WS_WIN) + (size_t)layer * PW * DM, DM, nM, PW / 256, G, (int)blockIdx.x);
        if (layer == 1) { S.nXN = 4; S.nx = 16; S.xm0 = 32; S.xn0 = 8; }
        EpiWin E{R1, rope};
        pg8::gemm_phase<EpiWin>(lds, DM, DM, S, E);
        SEAM(pb + 1);
    }
    if (EN(4) && IN(pb + 2)) { phase_attn(a, layer, lds); SEAM(pb + 2); }
    if (EN(5) && IN(pb + 3)) {
        pg8::Order S; S.init(Y, (const bf16_t*)(ws + WS_WMG) + (size_t)layer * DM * 2 * DM, 2 * DM, nM, DM / 256, G, (int)blockIdx.x); S.split2 = 1; S.khalf = (size_t)DM * 2;
        EpiMerge E{R1, (float*)(ws + WS_AS), MB};
        pg8::gemm_phase<EpiMerge>(lds, DM, 2 * DM, S, E);
        SEAM(pb + 3);
    }
    if (EN(6) && IN(pb + 4)) {
        pg8::Order S; S.init(MB, (const bf16_t*)(ws + WS_WOUT) + (size_t)layer * DM * DM, DM, nM, DM / 256, G, (int)blockIdx.x);
        EpiResid E{layer == 0 ? a.x : X, layer == 0 ? a.ctx : X + (size_t)MLAT * DM, X, mt + 2 * DM};
        pg8::gemm_phase<EpiResid>(lds, DM, DM, S, E);
        SEAM(pb + 4);
    }
    if (EN(7) && IN(pb + 5)) {
        if constexpr (layer == 0) phase_norm(a, 0, 3, MALL, gw, NGW, lane); else phase_norm2_router(a, lds, wave, lane);
        SEAM(pb + 5);
    }
    if constexpr (layer == 1) { if (EN(8) && IN(pb + 6)) { phase_moe_assign(a, lds, wave, lane, gw, NGW); SEAM(pb + 6); } }
    if (EN(9) && IN(pb + 7)) {
        pg8::Order S;
        if constexpr (layer == 0) S.init(H, (const bf16_t*)(ws + WS_WF13), DM, nM, 2 * DFF / 256, G, (int)blockIdx.x);
        else { S.init((const bf16_t*)(ws + WS_AS), (const bf16_t*)(ws + WS_WM13), DM, mi[MI_NPAN], 2 * DFE / 256, G, (int)blockIdx.x); S.pane = mi + MI_PANE; S.estride = (size_t)2 * DFE * DM * 2; }
        EpiSwiglu E{R1, layer == 0 ? DFF : DFE};
        pg8::gemm_phase<EpiSwiglu>(lds, DM, DM, S, E);
        SEAM(pb + 7);
    }
    if (EN(10) && IN(pb + 8)) {
        pg8::Order S; constexpr int Kd = layer == 0 ? DFF : DFE;
        if constexpr (layer == 0) S.init(R1, (const bf16_t*)(ws + WS_WF2), DFF, nM, DM / 256, G, (int)blockIdx.x);
        else { S.init(R1, (const bf16_t*)(ws + WS_WM2), DFE, mi[MI_NPAN], DM / 256, G, (int)blockIdx.x); S.pane = mi + MI_PANE; S.estride = (size_t)DM * DFE * 2; }
        EpiDown E{layer, X, mt + 5 * DM, (bf16_t*)(ws + WS_OS)};
        pg8::gemm_phase<EpiDown>(lds, Kd, Kd, S, E);
        SEAM(pb + 8);
    }
    if constexpr (layer == 1) { if (EN(11) && IN(pb + 9)) { phase_combine(a, gw, NGW, lane); } }
}

__global__ void __launch_bounds__(NWAVES * 64, 2) mk_fwd(Args a) {
    extern __shared__ __attribute__((aligned(16))) unsigned char lds_raw[];
    LAS unsigned char* lds = (LAS unsigned char*)lds_raw;
    volatile LAS unsigned* MISC = (volatile LAS unsigned*)(lds + MISC_OFF);
    const int tid = threadIdx.x, lane = tid & 63, wave = __builtin_amdgcn_readfirstlane(tid >> 6);
    const int G = gridDim.x, gw = blockIdx.x * NWAVES + wave, NGW = G * NWAVES;
    unsigned char* ws = a.ws;
    for (int u = tid; u < 64; u += NWAVES * 64) MISC[u] = 0u;
    __syncthreads();
    XcdBarrier bar; bar.bar = (unsigned*)(ws + WS_CTL) + CW_BAR; bar.x = 0; bar.st = nullptr;
    if (!MK_SPLIT) bar = xcd_barrier_post((unsigned*)(ws + WS_CTL) + CW_BAR, MISC + 8);
    const int lo = a.ph_lo, hi = a.ph_hi;
    if (EN(0) && IN(0)) { phase_prologue(a, lds, gw, NGW, wave, lane); SEAM(0); }
    if (EN(1) && IN(1)) { phase_modreduce(a); SEAM(1); }
    run_layer<0>(a, lds, bar, lo, hi);
    run_layer<1>(a, lds, bar, lo, hi);
}
#undef IN
#undef SEAM

extern "C" void kernel_launch(void* const* d_in, const int* in_sizes, int n_in, void* d_out, int out_size, void* d_ws, size_t ws_size, hipStream_t stream) {
    static int grid = 0;
    if (grid == 0) {
        if (n_in != 22 || out_size != MLAT * DM || ws_size < WS_END) { fprintf(stderr, "kernel_launch: unexpected shapes (n_in %d out %d ws %zu need %zu)\n", n_in, out_size, ws_size, (size_t)WS_END); grid = -1; return; }
        int dev = 0, cus = 0, per_cu = 0;
        if (hipGetDevice(&dev) != hipSuccess || hipDeviceGetAttribute(&cus, hipDeviceAttributeMultiprocessorCount, dev) != hipSuccess) { grid = -1; return; }
        if (hipFuncSetAttribute((const void*)mk_fwd, hipFuncAttributeMaxDynamicSharedMemorySize, LDS_BYTES) != hipSuccess) { fprintf(stderr, "kernel_launch: hipFuncSetAttribute failed\n"); grid = -1; return; }
        if (hipOccupancyMaxActiveBlocksPerMultiprocessor(&per_cu, (const void*)mk_fwd, NWAVES * 64, LDS_BYTES) != hipSuccess || per_cu < 1) { fprintf(stderr, "kernel_launch: occupancy query says %d\n", per_cu); }
        (void)hipGetLastError();
        grid = cus < 256 ? cus : 256;
    }
    if (grid < 0) return;
    if (hipMemsetAsync((char*)d_ws + WS_CTL, 0, CTL_BYTES, stream) != hipSuccess) return;
    Args a{};
    const float** ap = (const float**)&a;
    for (int i = 0; i < 22; ++i) ap[i] = (const float*)d_in[i];
    a.out = (float*)d_out; a.ws = (unsigned char*)d_ws;
#if MK_SPLIT
    for (int p = 0; p < N_PHASES; ++p) { if (p == 8 || p == 11) continue; a.ph_lo = p; a.ph_hi = p + 1; hipLaunchKernelGGL(mk_fwd, dim3(grid), dim3(NWAVES * 64), LDS_BYTES, stream, a); }
#else
    a.ph_lo = 0; a.ph_hi = N_PHASES;
    hipLaunchKernelGGL(mk_fwd, dim3(grid), dim3(NWAVES * 64), LDS_BYTES, stream, a);
#endif
}
```
